# Optimizing an MI355X kernel written in HIP

```python
import math
import jax
import jax.numpy as jnp
from jax import lax
import numpy as np

D_MODEL = 1024
BATCH = 2
SEQ = 8192
DEPTH = 2

HEAD_DIM = 64
N_META = 16
M_HEADS = 4
M_WIDTH = M_HEADS * HEAD_DIM
M_CHUNK = 64
M_NORM_EPS = 1e-6
R_HEADS = 4
R_WIDTH = R_HEADS * HEAD_DIM
R_DECAY_RANK = 32
R_A_RANK = 32
R_GATE_RANK = 64
R_GN_EPS = 64e-5
A_HEADS = 8
A_KV_HEADS = 2
A_GROUP = A_HEADS // A_KV_HEADS
A_WIDTH = A_HEADS * HEAD_DIM
A_KV_WIDTH = A_KV_HEADS * HEAD_DIM
WINDOW = 128
A_BLOCK = 128
N_BUCKETS = 32
MAX_DISTANCE = 128
MIX_WIDTH = M_WIDTH + R_WIDTH + A_WIDTH
D_FF = int(math.ceil(8 * D_MODEL / 3 / 256)) * 256
DEEPNORM_ALPHA = (2 * DEPTH) ** 0.25
DEEPNORM_BETA = (8 * DEPTH) ** -0.25
LN_EPS = 1e-5
NEG = -1e30
IN_SIZES = (A_WIDTH, A_KV_WIDTH, A_KV_WIDTH,
            M_WIDTH, M_WIDTH, M_WIDTH, M_WIDTH,
            M_HEADS, M_HEADS,
            R_WIDTH, R_WIDTH, R_WIDTH,
            R_DECAY_RANK, R_A_RANK, R_GATE_RANK)
IN_DIM = sum(IN_SIZES)
IN_SPLITS = tuple(int(s) for s in np.cumsum(IN_SIZES)[:-1])

kernel_name = 'hybrid_mlstm_rwkv7_swa_deepnorm'


def layer_norm(x, g, b, eps=LN_EPS):
    xf = x.astype(jnp.float32)
    mu = jnp.mean(xf, axis=-1, keepdims=True)
    var = jnp.mean(jnp.square(xf - mu), axis=-1, keepdims=True)
    return ((xf - mu) * lax.rsqrt(var + eps) * g + b).astype(x.dtype)


def head_norm(y, eps):
    mu = jnp.mean(y, axis=-1, keepdims=True)
    var = jnp.mean(jnp.square(y - mu), axis=-1, keepdims=True)
    return (y - mu) * lax.rsqrt(var + eps)


def token_shift_lerp(t, mu):
    prev = jnp.pad(t, ((0, 0), (1, 0), (0, 0)))[:, :-1]
    return t + (prev - t) * mu


def t5_bucket(dist):
    max_exact = N_BUCKETS // 2
    d = jnp.maximum(dist, 1).astype(jnp.float32)
    large = max_exact + (jnp.log(d / max_exact) / math.log(MAX_DISTANCE / max_exact)
                         * (N_BUCKETS - max_exact)).astype(jnp.int32)
    large = jnp.minimum(large, N_BUCKETS - 1)
    return jnp.where(dist < max_exact, dist, large)


def mlstm(q, k, v, o_pre, i_pre, f_pre, norm_w):
    B, L, _ = q.shape
    pad = M_CHUNK - N_META
    Lp = L + pad
    NC = Lp // M_CHUNK

    def heads(t):
        t = t.astype(jnp.float32).reshape(B, L, M_HEADS, HEAD_DIM)
        t = jnp.pad(t, ((0, 0), (pad, 0), (0, 0), (0, 0)))
        return t.reshape(B, NC, M_CHUNK, M_HEADS, HEAD_DIM).transpose(1, 0, 3, 2, 4)

    def gates(t, fill):
        t = jnp.pad(t.astype(jnp.float32), ((0, 0), (pad, 0), (0, 0)), constant_values=fill)
        return t.reshape(B, NC, M_CHUNK, M_HEADS).transpose(1, 0, 3, 2)

    qc = heads(q)
    kc = heads(k) * (HEAD_DIM ** -0.5)
    vc = heads(v)
    log_f = gates(jax.nn.log_sigmoid(f_pre.astype(jnp.float32)), 0.0)
    log_i = gates(i_pre, NEG)
    causal = jnp.tril(jnp.ones((M_CHUNK, M_CHUNK), dtype=bool))

    def step(carry, inp):
        C, n, m = carry
        qt, kt, vt, lf, li = inp
        b = jnp.cumsum(lf, axis=-1)
        D = jnp.where(causal, b[..., :, None] - b[..., None, :] + li[..., None, :], NEG)
        inter = b + m[..., None]
        m_t = jnp.maximum(jnp.max(D, axis=-1), inter)
        Dw = jnp.where(causal, jnp.exp(D - m_t[..., None]), 0.0)
        S = jnp.einsum('bhtd,bhsd->bhts', qt, kt) * Dw
        s_inter = jnp.exp(inter - m_t)
        num = (jnp.einsum('bhts,bhsd->bhtd', S, vt)
               + s_inter[..., None] * jnp.einsum('bhvk,bhtk->bhtv', C, qt))
        den = jnp.sum(S, axis=-1) + s_inter * jnp.einsum('bhk,bhtk->bht', n, qt)
        h = num / jnp.maximum(jnp.abs(den), jnp.exp(-m_t))[..., None]
        g = b[..., -1]
        a = g[..., None] - b + li
        m_new = jnp.maximum(g + m, jnp.max(a, axis=-1))
        wa = jnp.exp(a - m_new[..., None])
        decay = jnp.exp(g + m - m_new)
        C_new = decay[..., None, None] * C + jnp.einsum('bhs,bhsv,bhsk->bhvk', wa, vt, kt)
        n_new = decay[..., None] * n + jnp.einsum('bhs,bhsk->bhk', wa, kt)
        return (C_new, n_new, m_new), h

    carry0 = (jnp.zeros((B, M_HEADS, HEAD_DIM, HEAD_DIM), jnp.float32),
              jnp.zeros((B, M_HEADS, HEAD_DIM), jnp.float32),
              jnp.full((B, M_HEADS), NEG, jnp.float32))
    _, h = lax.scan(step, carry0, (qc, kc, vc, log_f, log_i))
    h = h.transpose(1, 0, 3, 2, 4).reshape(B, Lp, M_HEADS, HEAD_DIM)[:, pad:]
    h = head_norm(h, M_NORM_EPS).reshape(B, L, M_WIDTH) * norm_w
    return h * jax.nn.sigmoid(o_pre.astype(jnp.float32))


def rwkv7(r, k, v, w_lat, a_lat, g_lat, mu_rkv, mu_w, mu_a, mu_g, w0, w2, a0, a2, g2,
          k_k, k_a, r_k, ln_x):
    B, L, _ = r.shape
    f32 = lambda t: t.astype(jnp.float32)
    r = token_shift_lerp(f32(r), mu_rkv[0])
    k = token_shift_lerp(f32(k), mu_rkv[1])
    v = token_shift_lerp(f32(v), mu_rkv[2])
    w_lat = token_shift_lerp(f32(w_lat), mu_w)
    a_lat = token_shift_lerp(f32(a_lat), mu_a)
    g_lat = token_shift_lerp(f32(g_lat), mu_g)
    w_log = -jax.nn.softplus(-(w0 + jnp.tanh(w_lat) @ w2)) - 0.5
    decay = jnp.exp(-jnp.exp(w_log))
    a = jax.nn.sigmoid(a0 + a_lat @ a2)
    g = jax.nn.sigmoid(g_lat) @ g2
    hd = lambda t: t.reshape(B, L, R_HEADS, HEAD_DIM)
    kk = hd(k * k_k)
    kk = kk / jnp.maximum(jnp.sqrt(jnp.sum(kk * kk, axis=-1, keepdims=True)), 1e-12)
    k = k * (1.0 + (a - 1.0) * k_a)
    r_h, k_h, v_h, w_h, a_h = hd(r), hd(k), hd(v), hd(decay), hd(a)

    def step(S, inp):
        rt, wt, kt, vt, at, bt = inp
        sa = jnp.einsum('bhvk,bhk->bhv', S, at)
        S = S * wt[:, :, None, :] + sa[..., None] * bt[:, :, None, :] + vt[..., None] * kt[:, :, None, :]
        return S, jnp.einsum('bhvk,bhk->bhv', S, rt)

    tm = lambda t: jnp.moveaxis(t, 1, 0)
    S0 = jnp.zeros((B, R_HEADS, HEAD_DIM, HEAD_DIM), jnp.float32)
    _, y = lax.scan(step, S0, (tm(r_h), tm(w_h), tm(k_h), tm(v_h), tm(-kk), tm(kk * a_h)))
    y = jnp.moveaxis(y, 0, 1)
    y = head_norm(y, R_GN_EPS).reshape(B, L, R_WIDTH) * ln_x[0] + ln_x[1]
    bonus = jnp.sum(r_h * k_h * r_k.reshape(R_HEADS, HEAD_DIM), axis=-1, keepdims=True) * v_h
    return (y + bonus.reshape(B, L, R_WIDTH)) * g


def sliding_window_attention(q, k, v, sinks, rel_bias):
    B, L, _ = q.shape
    pad = A_BLOCK - N_META
    Lp = L + pad
    NB = Lp // A_BLOCK
    q = q.reshape(B, L, A_KV_HEADS, A_GROUP, HEAD_DIM)
    k = k.reshape(B, L, A_KV_HEADS, HEAD_DIM)
    v = v.reshape(B, L, A_KV_HEADS, HEAD_DIM)
    k_meta, v_meta = k[:, :N_META], v[:, :N_META]
    qb = jnp.pad(q, ((0, 0), (pad, 0), (0, 0), (0, 0), (0, 0))).reshape(
        B, NB, A_BLOCK, A_KV_HEADS, A_GROUP, HEAD_DIM)
    kb = jnp.pad(k, ((0, 0), (pad + A_BLOCK, 0), (0, 0), (0, 0))).reshape(
        B, NB + 1, A_BLOCK, A_KV_HEADS, HEAD_DIM)
    vb = jnp.pad(v, ((0, 0), (pad + A_BLOCK, 0), (0, 0), (0, 0))).reshape(
        B, NB + 1, A_BLOCK, A_KV_HEADS, HEAD_DIM)
    k_band = jnp.concatenate([kb[:, :-1], kb[:, 1:]], axis=2)
    v_band = jnp.concatenate([vb[:, :-1], vb[:, 1:]], axis=2)
    scale = HEAD_DIM ** -0.5
    s_band = jnp.einsum('bnikgd,bnjkd->bkgnij', qb, k_band).astype(jnp.float32) * scale
    s_meta = jnp.einsum('bnikgd,bmkd->bkgnim', qb, k_meta).astype(jnp.float32) * scale

    q_pos = jnp.arange(NB)[:, None] * A_BLOCK + jnp.arange(A_BLOCK)[None, :] - pad
    kb_pos = jnp.arange(NB)[:, None] * A_BLOCK - A_BLOCK + jnp.arange(2 * A_BLOCK)[None, :] - pad
    dist_band = A_BLOCK + jnp.arange(A_BLOCK)[:, None] - jnp.arange(2 * A_BLOCK)[None, :]
    band_ok = ((dist_band >= 0) & (dist_band < WINDOW))[None] & (kb_pos[:, None, :] >= N_META)
    dist_meta = q_pos[:, :, None] - jnp.arange(N_META)[None, None, :]
    meta_ok = dist_meta >= 0
    rb = rel_bias.astype(jnp.float32)
    bias_band = rb[:, t5_bucket(jnp.maximum(dist_band, 0))].reshape(
        A_KV_HEADS, A_GROUP, 1, A_BLOCK, 2 * A_BLOCK)
    bias_meta = rb[:, t5_bucket(jnp.maximum(dist_meta, 0))].reshape(
        A_KV_HEADS, A_GROUP, NB, A_BLOCK, N_META)
    s_band = jnp.where(band_ok, s_band + bias_band, NEG)
    s_meta = jnp.where(meta_ok, s_meta + bias_meta, NEG)
    sink = jnp.broadcast_to(sinks.astype(jnp.float32).reshape(A_KV_HEADS, A_GROUP, 1, 1, 1),
                            (B, A_KV_HEADS, A_GROUP, NB, A_BLOCK, 1))
    p = jax.nn.softmax(jnp.concatenate([s_meta, s_band, sink], axis=-1), axis=-1)
    p_meta = p[..., :N_META].astype(v.dtype)
    p_band = p[..., N_META:N_META + 2 * A_BLOCK].astype(v.dtype)
    out = (jnp.einsum('bkgnim,bmkd->bnikgd', p_meta, v_meta)
           + jnp.einsum('bkgnij,bnjkd->bnikgd', p_band, v_band))
    return out.reshape(B, Lp, A_WIDTH)[:, pad:]


def setup_inputs(seed: int = 0) -> dict:
    key = jax.random.key(seed)
    keys = jax.random.split(key, 32)
    cnt = [0]

    def nk():
        cnt[0] += 1
        return keys[cnt[0] - 1]

    nrm = lambda shape, s: jax.random.normal(nk(), shape, jnp.float32) * s
    uni = lambda shape, lo, hi: jax.random.uniform(nk(), shape, jnp.float32, lo, hi)
    ln_pair = lambda: jnp.stack([1.0 + nrm((DEPTH, D_MODEL), 0.02), nrm((DEPTH, D_MODEL), 0.02)], axis=1)
    return {
        'x': nrm((BATCH, SEQ, D_MODEL), 1.0),
        'meta_tokens': nrm((N_META, D_MODEL), 1.0),
        'rel_bias': nrm((A_HEADS, N_BUCKETS), 0.5),
        'w_in': nrm((DEPTH, D_MODEL, IN_DIM), D_MODEL ** -0.5),
        'm_gate_bias': jnp.stack([nrm((DEPTH, M_HEADS), 0.5), uni((DEPTH, M_HEADS), 3.0, 6.0)], axis=1),
        'm_norm_w': 1.0 + nrm((DEPTH, M_WIDTH), 0.02),
        'r_mu_rkv': uni((DEPTH, 3, R_WIDTH), 0.0, 1.0),
        'r_mu_w': uni((DEPTH, R_DECAY_RANK), 0.0, 1.0),
        'r_mu_a': uni((DEPTH, R_A_RANK), 0.0, 1.0),
        'r_mu_g': uni((DEPTH, R_GATE_RANK), 0.0, 1.0),
        'r_w0': uni((DEPTH, R_WIDTH), -6.5, 0.0),
        'r_w2': nrm((DEPTH, R_DECAY_RANK, R_WIDTH), 0.1 * R_DECAY_RANK ** -0.5),
        'r_a0': nrm((DEPTH, R_WIDTH), 0.1),
        'r_a2': nrm((DEPTH, R_A_RANK, R_WIDTH), 0.1 * R_A_RANK ** -0.5),
        'r_g2': nrm((DEPTH, R_GATE_RANK, R_WIDTH), R_GATE_RANK ** -0.5),
        'r_k_k': 0.85 + nrm((DEPTH, R_WIDTH), 0.02),
        'r_k_a': 1.0 + nrm((DEPTH, R_WIDTH), 0.02),
        'r_r_k': nrm((DEPTH, R_WIDTH), 0.1),
        'r_ln_x': jnp.stack([1.0 + nrm((DEPTH, R_WIDTH), 0.02), nrm((DEPTH, R_WIDTH), 0.02)], axis=1),
        'a_sinks': nrm((DEPTH, A_HEADS), 0.5),
        'w_out': nrm((DEPTH, MIX_WIDTH, D_MODEL), DEEPNORM_BETA * MIX_WIDTH ** -0.5),
        'ln_mix': ln_pair(),
        'w_ff_in': nrm((DEPTH, D_MODEL, 2 * D_FF), D_MODEL ** -0.5),
        'w_ff_out': nrm((DEPTH, D_FF, D_MODEL), DEEPNORM_BETA * D_FF ** -0.5),
        'ln_ffn': ln_pair(),
    }


def reference(x, meta_tokens, rel_bias, w_in, m_gate_bias, m_norm_w, r_mu_rkv, r_mu_w, r_mu_a,
              r_mu_g, r_w0, r_w2, r_a0, r_a2, r_g2, r_k_k, r_k_a, r_r_k, r_ln_x, a_sinks, w_out,
              ln_mix, w_ff_in, w_ff_out, ln_ffn):
    B = x.shape[0]
    meta = jnp.broadcast_to(meta_tokens[None].astype(x.dtype), (B, N_META, D_MODEL))
    h = jnp.concatenate([meta, x], axis=1)
    for l in range(DEPTH):
        proj = h @ w_in[l]
        (aq, ak, av, mq, mk, mv, mo, mi, mf,
         rr, rk, rv, rw, ra, rg) = jnp.split(proj, IN_SPLITS, axis=-1)
        y_m = mlstm(mq, mk, mv, mo, mi + m_gate_bias[l, 0], mf + m_gate_bias[l, 1], m_norm_w[l])
        y_r = rwkv7(rr, rk, rv, rw, ra, rg, r_mu_rkv[l], r_mu_w[l], r_mu_a[l], r_mu_g[l],
                    r_w0[l], r_w2[l], r_a0[l], r_a2[l], r_g2[l], r_k_k[l], r_k_a[l], r_r_k[l],
                    r_ln_x[l])
        y_a = sliding_window_attention(aq, ak, av, a_sinks[l], rel_bias)
        mix = jnp.concatenate([y_m.astype(h.dtype), y_r.astype(h.dtype), y_a.astype(h.dtype)],
                              axis=-1) @ w_out[l]
        h = layer_norm(DEEPNORM_ALPHA * h + mix, ln_mix[l, 0], ln_mix[l, 1])
        gate, up = jnp.split(h @ w_ff_in[l], 2, axis=-1)
        ffn = (jax.nn.silu(gate) * up) @ w_ff_out[l]
        h = layer_norm(DEEPNORM_ALPHA * h + ffn, ln_ffn[l, 0], ln_ffn[l, 1])
    return h[:, N_META:]
```

```cpp
#include <hip/hip_runtime.h>
#include <cstdio>
#include <cstdint>

constexpr int D = 1024, NB = 2, SEQ = 8192, NM = 16, L = SEQ + NM, T = NB * L, DEPTH = 2;
constexpr int IN_DIM = 2696, DFF = 2816;
constexpr float ALPHA = 1.41421356237309515f;
constexpr float LN_EPS = 1e-5f;
constexpr float NEGF = -1e30f;

__constant__ unsigned char T5B[128] = {0, 1, 2, 3, 4, 5, 6, 7, 8, 9, 10, 11, 12, 13, 14, 15, 16, 16, 16, 17, 17, 18, 18, 18, 19, 19, 19, 20, 20, 20, 20, 21, 21, 21, 21, 22, 22, 22, 22, 22, 23, 23, 23, 23, 23, 23, 24, 24, 24, 24, 24, 24, 25, 25, 25, 25, 25, 25, 25, 26, 26, 26, 26, 26, 26, 26, 26, 27, 27, 27, 27, 27, 27, 27, 27, 27, 27, 28, 28, 28, 28, 28, 28, 28, 28, 28, 28, 29, 29, 29, 29, 29, 29, 29, 29, 29, 29, 29, 29, 30, 30, 30, 30, 30, 30, 30, 30, 30, 30, 30, 30, 30, 30, 31, 31, 31, 31, 31, 31, 31, 31, 31, 31, 31, 31, 31, 31, 31};

__device__ __forceinline__ float sigmoidf_(float x) { return 1.0f / (1.0f + expf(-x)); }
__device__ __forceinline__ float softplusf_(float x) { return x > 0.f ? x + log1pf(expf(-x)) : log1pf(expf(x)); }
__device__ __forceinline__ float logsigmoidf_(float x) { return -softplusf_(-x); }
__device__ __forceinline__ float wave_sum(float v) {
#pragma unroll
    for (int o = 1; o < 64; o <<= 1) v += __shfl_xor(v, o);
    return v;
}
__device__ __forceinline__ float wave_max(float v) {
#pragma unroll
    for (int o = 1; o < 64; o <<= 1) v = fmaxf(v, __shfl_xor(v, o));
    return v;
}

__global__ void __launch_bounds__(256) k_init_h(const float* __restrict__ x, const float* __restrict__ meta, float* __restrict__ h) {
    const int row = blockIdx.x, b = row / L, p = row % L;
    const float4* src = p < NM ? (const float4*)(meta + (size_t)p * D) : (const float4*)(x + ((size_t)b * SEQ + (p - NM)) * D);
    ((float4*)(h + (size_t)row * D))[threadIdx.x] = src[threadIdx.x];
}

template <int MODE>
__global__ void __launch_bounds__(256) k_gemm(const float* __restrict__ A, int lda, const float* __restrict__ W, int ldw, int wcol0, int wcol1,
                                              float* __restrict__ C, int ldc, int M, int N, int K) {
    __shared__ float As[16][68];
    __shared__ float Bs[16][68];
    __shared__ float B2[MODE == 2 ? 16 : 1][68];
    const int tid = threadIdx.x, tx = tid & 15, ty = tid >> 4;
    const int m0 = blockIdx.y * 64, n0 = blockIdx.x * 64;
    float acc[4][4], acc2[4][4];
#pragma unroll
    for (int i = 0; i < 4; ++i)
#pragma unroll
        for (int j = 0; j < 4; ++j) { acc[i][j] = 0.f; acc2[i][j] = 0.f; }
    const int ar = tid >> 2, akq = (tid & 3) * 4;
    const int bk = tid >> 4, bn = (tid & 15) * 4;
    for (int k0 = 0; k0 < K; k0 += 16) {
        float4 av = make_float4(0.f, 0.f, 0.f, 0.f);
        if (m0 + ar < M) av = *(const float4*)(A + (size_t)(m0 + ar) * lda + k0 + akq);
        As[akq + 0][ar] = av.x; As[akq + 1][ar] = av.y; As[akq + 2][ar] = av.z; As[akq + 3][ar] = av.w;
        float4 bv = make_float4(0.f, 0.f, 0.f, 0.f), bv2 = bv;
        if (n0 + bn < N) {
            bv = *(const float4*)(W + (size_t)(k0 + bk) * ldw + wcol0 + n0 + bn);
            if (MODE == 2) bv2 = *(const float4*)(W + (size_t)(k0 + bk) * ldw + wcol1 + n0 + bn);
        }
        *(float4*)&Bs[bk][bn] = bv;
        if (MODE == 2) *(float4*)&B2[bk][bn] = bv2;
        __syncthreads();
#pragma unroll
        for (int kk = 0; kk < 16; ++kk) {
            const float4 a = *(const float4*)&As[kk][ty * 4];
            const float4 b = *(const float4*)&Bs[kk][tx * 4];
            const float aa[4] = {a.x, a.y, a.z, a.w}, bb[4] = {b.x, b.y, b.z, b.w};
#pragma unroll
            for (int i = 0; i < 4; ++i)
#pragma unroll
                for (int j = 0; j < 4; ++j) acc[i][j] = fmaf(aa[i], bb[j], acc[i][j]);
            if (MODE == 2) {
                const float4 c = *(const float4*)&B2[kk][tx * 4];
                const float cc[4] = {c.x, c.y, c.z, c.w};
#pragma unroll
                for (int i = 0; i < 4; ++i)
#pragma unroll
                    for (int j = 0; j < 4; ++j) acc2[i][j] = fmaf(aa[i], cc[j], acc2[i][j]);
            }
        }
        __syncthreads();
    }
#pragma unroll
    for (int i = 0; i < 4; ++i) {
        const int r = m0 + ty * 4 + i;
        if (r >= M) continue;
#pragma unroll
        for (int j = 0; j < 4; ++j) {
            const int c = n0 + tx * 4 + j;
            if (c >= N) continue;
            float* o = C + (size_t)r * ldc + c;
            if (MODE == 0) *o = acc[i][j];
            else if (MODE == 1) *o += acc[i][j];
            else { const float g = acc[i][j]; *o = (g / (1.0f + expf(-g))) * acc2[i][j]; }
        }
    }
}

__global__ void __launch_bounds__(256) k_resid_ln(float* __restrict__ h, const float* __restrict__ add, const float* __restrict__ g, const float* __restrict__ bta, float* __restrict__ out) {
    __shared__ float red[8];
    const int row = blockIdx.x, tid = threadIdx.x;
    const float4 hv = ((const float4*)(h + (size_t)row * D))[tid], av = ((const float4*)(add + (size_t)row * D))[tid];
    float v[4] = {ALPHA * hv.x + av.x, ALPHA * hv.y + av.y, ALPHA * hv.z + av.z, ALPHA * hv.w + av.w};
    float s = wave_sum((v[0] + v[1]) + (v[2] + v[3]));
    if ((tid & 63) == 0) red[tid >> 6] = s;
    __syncthreads();
    const float mean = (red[0] + red[1] + red[2] + red[3]) * (1.0f / D);
    float q = 0.f;
#pragma unroll
    for (int i = 0; i < 4; ++i) { v[i] -= mean; q += v[i] * v[i]; }
    q = wave_sum(q);
    if ((tid & 63) == 0) red[4 + (tid >> 6)] = q;
    __syncthreads();
    const float rstd = rsqrtf((red[4] + red[5] + red[6] + red[7]) * (1.0f / D) + LN_EPS);
    const float4 gv = ((const float4*)g)[tid], bv = ((const float4*)bta)[tid];
    float4 o; o.x = v[0] * rstd * gv.x + bv.x; o.y = v[1] * rstd * gv.y + bv.y; o.z = v[2] * rstd * gv.z + bv.z; o.w = v[3] * rstd * gv.w + bv.w;
    ((float4*)(h + (size_t)row * D))[tid] = o;
    if (out) { const int b = row / L, p = row % L; if (p >= NM) ((float4*)(out + ((size_t)b * SEQ + (p - NM)) * D))[tid] = o; }
}

constexpr int MP = 1032;
__global__ void __launch_bounds__(256) k_mlstm(const float* __restrict__ pp, const float* __restrict__ gbias, const float* __restrict__ normw, float* __restrict__ mix) {
    extern __shared__ float sm[];
    float (*q)[65] = (float (*)[65])(sm);
    float (*k)[65] = (float (*)[65])(sm + 64 * 65);
    float (*v)[65] = (float (*)[65])(sm + 2 * 64 * 65);
    float (*Cs)[65] = (float (*)[65])(sm + 3 * 64 * 65);
    float (*Ss)[65] = (float (*)[65])(sm + 4 * 64 * 65);
    float* nn = sm + 5 * 64 * 65;
    float* bc = nn + 64;
    float* li = bc + 64;
    float* lf = li + 64;
    float* mt = lf + 64;
    float* sint = mt + 64;
    float* den = sint + 64;
    float* wa = den + 64;
    float* sc = wa + 64;
    const int b = blockIdx.x >> 2, h = blockIdx.x & 3, tid = threadIdx.x;
    for (int i = tid; i < 64 * 65; i += 256) (&Cs[0][0])[i] = 0.f;
    if (tid < 64) nn[tid] = 0.f;
    if (tid == 0) sc[0] = NEGF;
    const float bias_i = gbias[h], bias_f = gbias[4 + h];
    __syncthreads();
    for (int c = 0; c < (L + 48) / 64; ++c) {
        for (int idx = tid; idx < 4096; idx += 256) {
            const int s = idx >> 6, d = idx & 63, p = c * 64 + s - 48;
            float qv = 0.f, kv = 0.f, vv = 0.f;
            if (p >= 0) { const float* r = pp + (size_t)(b * L + p) * MP + h * 64 + d; qv = r[0]; kv = r[256] * 0.125f; vv = r[512]; }
            q[s][d] = qv; k[s][d] = kv; v[s][d] = vv;
        }
        if (tid < 64) {
            const int p = c * 64 + tid - 48;
            float l_i = NEGF, l_f = 0.f;
            if (p >= 0) { const float* r = pp + (size_t)(b * L + p) * MP; l_i = r[1024 + h] + bias_i; l_f = logsigmoidf_(r[1028 + h] + bias_f); }
            li[tid] = l_i; lf[tid] = l_f;
        }
        __syncthreads();
        if (tid == 0) { float a = 0.f; for (int s = 0; s < 64; ++s) { a += lf[s]; bc[s] = a; } }
        __syncthreads();
        const float m_old = sc[0];
        if (tid < 64) {
            const int t = tid; float mx = NEGF;
            for (int s = 0; s <= t; ++s) mx = fmaxf(mx, bc[t] - bc[s] + li[s]);
            const float inter = bc[t] + m_old;
            const float m_t = fmaxf(mx, inter);
            mt[t] = m_t; sint[t] = expf(inter - m_t);
        }
        __syncthreads();
        for (int idx = tid; idx < 4096; idx += 256) {
            const int t = idx >> 6, s = idx & 63;
            float val = 0.f;
            if (s <= t) {
                float dot = 0.f;
                for (int d = 0; d < 64; ++d) dot = fmaf(q[t][d], k[s][d], dot);
                val = dot * expf(bc[t] - bc[s] + li[s] - mt[t]);
            }
            Ss[t][s] = val;
        }
        __syncthreads();
        if (tid < 64) {
            const int t = tid; float a = 0.f, nq = 0.f;
            for (int s = 0; s < 64; ++s) a += Ss[t][s];
            for (int d = 0; d < 64; ++d) nq = fmaf(nn[d], q[t][d], nq);
            den[t] = a + sint[t] * nq;
        }
        __syncthreads();
        float hv[16];
#pragma unroll
        for (int i = 0; i < 16; ++i) {
            const int idx = tid + i * 256, t = idx >> 6, dv = idx & 63;
            float a = 0.f, cq = 0.f;
            for (int s = 0; s < 64; ++s) a = fmaf(Ss[t][s], v[s][dv], a);
            for (int d = 0; d < 64; ++d) cq = fmaf(Cs[dv][d], q[t][d], cq);
            const float num = a + sint[t] * cq;
            hv[i] = num / fmaxf(fabsf(den[t]), expf(-mt[t]));
        }
        __syncthreads();
#pragma unroll
        for (int i = 0; i < 16; ++i) { const int idx = tid + i * 256; Ss[idx >> 6][idx & 63] = hv[i]; }
        __syncthreads();
        {
            const int w = tid >> 6, dv = tid & 63;
            for (int t = w; t < 64; t += 4) {
                const int p = c * 64 + t - 48;
                const float x = Ss[t][dv];
                const float mu = wave_sum(x) * (1.0f / 64.0f);
                const float dx = x - mu;
                const float var = wave_sum(dx * dx) * (1.0f / 64.0f);
                if (p >= 0) {
                    const size_t row = (size_t)(b * L + p);
                    const float o = pp[row * MP + 768 + h * 64 + dv];
                    mix[row * D + h * 64 + dv] = dx * rsqrtf(var + 1e-6f) * normw[h * 64 + dv] * sigmoidf_(o);
                }
            }
        }
        if (tid == 0) {
            const float g = bc[63]; float mx = NEGF;
            for (int s = 0; s < 64; ++s) mx = fmaxf(mx, g - bc[s] + li[s]);
            const float m_new = fmaxf(g + m_old, mx);
            sc[1] = expf(g + m_old - m_new); sc[2] = m_new;
        }
        __syncthreads();
        if (tid < 64) wa[tid] = expf(bc[63] - bc[tid] + li[tid] - sc[2]);
        __syncthreads();
        const float decay = sc[1];
        for (int idx = tid; idx < 4096; idx += 256) {
            const int dv = idx >> 6, dk = idx & 63;
            float a = 0.f;
            for (int s = 0; s < 64; ++s) a = fmaf(wa[s] * v[s][dv], k[s][dk], a);
            Cs[dv][dk] = decay * Cs[dv][dk] + a;
        }
        if (tid < 64) {
            float a = 0.f;
            for (int s = 0; s < 64; ++s) a = fmaf(wa[s], k[s][tid], a);
            nn[tid] = decay * nn[tid] + a;
        }
        __syncthreads();
        if (tid == 0) sc[0] = sc[2];
        __syncthreads();
    }
}

constexpr int RP = 896;
struct RwkvW { const float *mu_rkv, *mu_w, *mu_a, *mu_g, *w0, *w2, *a0, *a2, *g2, *k_k, *k_a, *r_k, *ln_x; };
__global__ void __launch_bounds__(256) k_rwkv_prep(const float* __restrict__ rp, RwkvW w, float* __restrict__ sR, float* __restrict__ sW, float* __restrict__ sK, float* __restrict__ sV, float* __restrict__ sA, float* __restrict__ sB) {
    __shared__ float wl[32], al[32];
    const int row = blockIdx.x, p = row % L, c = threadIdx.x;
    const float* cur = rp + (size_t)row * RP;
    const float* prv = cur - RP;
    const bool hp = p > 0;
    auto lerp = [&](int col, float mu) { const float t = cur[col]; const float pv = hp ? prv[col] : 0.f; return t + (pv - t) * mu; };
    const float r = lerp(c, w.mu_rkv[c]), k = lerp(256 + c, w.mu_rkv[256 + c]), v = lerp(512 + c, w.mu_rkv[512 + c]);
    if (c < 32) wl[c] = tanhf(lerp(768 + c, w.mu_w[c]));
    else if (c < 64) al[c - 32] = lerp(800 + c - 32, w.mu_a[c - 32]);
    __syncthreads();
    float wv = w.w0[c], av = w.a0[c];
    for (int j = 0; j < 32; ++j) { wv = fmaf(wl[j], w.w2[j * 256 + c], wv); av = fmaf(al[j], w.a2[j * 256 + c], av); }
    const float w_log = -softplusf_(-wv) - 0.5f;
    const float decay = expf(-expf(w_log));
    const float a = sigmoidf_(av);
    float kk = k * w.k_k[c];
    const float nrm = sqrtf(wave_sum(kk * kk));
    kk = kk / fmaxf(nrm, 1e-12f);
    const float k2 = k * (1.0f + (a - 1.0f) * w.k_a[c]);
    const size_t o = (size_t)row * 256 + c;
    sR[o] = r; sW[o] = decay; sK[o] = k2; sV[o] = v; sA[o] = -kk; sB[o] = kk * a;
}

__global__ void __launch_bounds__(1024) k_rwkv_scan(const float* __restrict__ sR, const float* __restrict__ sW, const float* __restrict__ sK, float* __restrict__ sV, const float* __restrict__ sA, const float* __restrict__ sB) {
    __shared__ float4 lr[32][16], lw[32][16], lk[32][16], la[32][16], lb[32][16];
    __shared__ float lv[32][64], ly[32][64];
    const int b = blockIdx.x >> 2, h = blockIdx.x & 3, tid = threadIdx.x, vrow = tid >> 4, l16 = tid & 15;
    float S[4] = {0.f, 0.f, 0.f, 0.f};
    for (int c0 = 0; c0 < L; c0 += 32) {
        const int ns = (L - c0) < 32 ? (L - c0) : 32;
        if (tid < 512) {
            const int s = tid >> 4, q4 = tid & 15;
            if (s < ns) {
                const size_t o = ((size_t)(b * L + c0 + s) * 256 + h * 64) / 4 + q4;
                lr[s][q4] = ((const float4*)sR)[o]; lw[s][q4] = ((const float4*)sW)[o]; lk[s][q4] = ((const float4*)sK)[o];
                la[s][q4] = ((const float4*)sA)[o]; lb[s][q4] = ((const float4*)sB)[o];
                ((float4*)&lv[s][0])[q4] = ((const float4*)sV)[o];
            }
        }
        __syncthreads();
        for (int s = 0; s < ns; ++s) {
            const float4 a4 = la[s][l16], w4 = lw[s][l16], b4 = lb[s][l16], k4 = lk[s][l16], r4 = lr[s][l16];
            const float vv = lv[s][vrow];
            float sa = (S[0] * a4.x + S[1] * a4.y) + (S[2] * a4.z + S[3] * a4.w);
            sa += __shfl_xor(sa, 1); sa += __shfl_xor(sa, 2); sa += __shfl_xor(sa, 4); sa += __shfl_xor(sa, 8);
            S[0] = S[0] * w4.x + sa * b4.x + vv * k4.x;
            S[1] = S[1] * w4.y + sa * b4.y + vv * k4.y;
            S[2] = S[2] * w4.z + sa * b4.z + vv * k4.z;
            S[3] = S[3] * w4.w + sa * b4.w + vv * k4.w;
            float y = (S[0] * r4.x + S[1] * r4.y) + (S[2] * r4.z + S[3] * r4.w);
            y += __shfl_xor(y, 1); y += __shfl_xor(y, 2); y += __shfl_xor(y, 4); y += __shfl_xor(y, 8);
            if (l16 == 0) ly[s][vrow] = y;
        }
        __syncthreads();
        for (int i = tid; i < ns * 64; i += 1024) { const int s = i >> 6, d = i & 63; sV[(size_t)(b * L + c0 + s) * 256 + h * 64 + d] = ly[s][d]; }
        __syncthreads();
    }
}

__global__ void __launch_bounds__(256) k_rwkv_post(const float* __restrict__ rp, RwkvW w, const float* __restrict__ sR, const float* __restrict__ sK, const float* __restrict__ sY, float* __restrict__ mix) {
    __shared__ float gl[64];
    const int row = blockIdx.x, p = row % L, c = threadIdx.x;
    const float* cur = rp + (size_t)row * RP;
    const float* prv = cur - RP;
    const bool hp = p > 0;
    auto lerp = [&](int col, float mu) { const float t = cur[col]; const float pv = hp ? prv[col] : 0.f; return t + (pv - t) * mu; };
    const float v = lerp(512 + c, w.mu_rkv[512 + c]);
    if (c < 64) gl[c] = sigmoidf_(lerp(832 + c, w.mu_g[c]));
    __syncthreads();
    float g = 0.f;
    for (int j = 0; j < 64; ++j) g = fmaf(gl[j], w.g2[j * 256 + c], g);
    const size_t o = (size_t)row * 256 + c;
    const float y = sY[o], r = sR[o], k2 = sK[o];
    const float mu = wave_sum(y) * (1.0f / 64.0f);
    const float dy = y - mu;
    const float var = wave_sum(dy * dy) * (1.0f / 64.0f);
    const float yn = dy * rsqrtf(var + 64e-5f) * w.ln_x[c] + w.ln_x[256 + c];
    const float bonus = wave_sum(r * k2 * w.r_k[c]) * v;
    mix[(size_t)row * D + 256 + c] = (yn + bonus) * g;
}

constexpr int AP = 768;
__global__ void __launch_bounds__(256) k_attn(const float* __restrict__ ap, const float* __restrict__ rel_bias, const float* __restrict__ sinks, float* __restrict__ mix) {
    __shared__ float qs[4][64];
    __shared__ float pw[4][192];
    __shared__ int pr[4][192];
    const int w = threadIdx.x >> 6, lane = threadIdx.x & 63;
    const int gq = blockIdx.x * 4 + w;
    const int p = gq % L, h = (gq / L) % 8, b = gq / (L * 8);
    const int kvh = h >> 2;
    const size_t qrow = (size_t)(b * L + p);
    qs[w][lane] = ap[qrow * AP + h * 64 + lane];
    __syncthreads();
    float sc[3]; int rows[3];
    float mx = sinks[h];
#pragma unroll
    for (int pass = 0; pass < 3; ++pass) {
        const int cand = pass * 64 + lane;
        int kp = -1, dist = 0;
        if (cand < 16) { if (cand <= p) { kp = cand; dist = p - cand; } }
        else if (cand < 144) { const int j = p - (cand - 16); if (j >= NM) { kp = j; dist = cand - 16; } }
        float s = NEGF;
        if (kp >= 0) {
            const float* kr = ap + (size_t)(b * L + kp) * AP + 512 + kvh * 64;
            float dot = 0.f;
#pragma unroll 16
            for (int d = 0; d < 64; ++d) dot = fmaf(qs[w][d], kr[d], dot);
            const int bucket = dist < 128 ? (int)T5B[dist] : 31;
            s = dot * 0.125f + rel_bias[h * 32 + bucket];
        }
        sc[pass] = s; rows[pass] = kp;
        mx = fmaxf(mx, s);
    }
    mx = wave_max(mx);
    float sum = 0.f;
#pragma unroll
    for (int pass = 0; pass < 3; ++pass) { const float e = rows[pass] >= 0 ? expf(sc[pass] - mx) : 0.f; sc[pass] = e; sum += e; }
    sum = wave_sum(sum) + expf(sinks[h] - mx);
    const float inv = 1.0f / sum;
#pragma unroll
    for (int pass = 0; pass < 3; ++pass) { pw[w][pass * 64 + lane] = sc[pass] * inv; pr[w][pass * 64 + lane] = rows[pass]; }
    __syncthreads();
    float o = 0.f;
    for (int cnd = 0; cnd < 144; ++cnd) {
        const int kp = pr[w][cnd];
        if (kp >= 0) o = fmaf(pw[w][cnd], ap[(size_t)(b * L + kp) * AP + 640 + kvh * 64 + lane], o);
    }
    mix[qrow * D + 512 + h * 64 + lane] = o;
}

extern "C" void kernel_launch(void* const* d_in, const int* in_sizes, int n_in, void* d_out, int out_size, void* d_ws, size_t ws_size, hipStream_t stream) {
    const float* x = (const float*)d_in[0];
    const float* meta = (const float*)d_in[1];
    const float* rel_bias = (const float*)d_in[2];
    const float* w_in = (const float*)d_in[3];
    const float* m_gate_bias = (const float*)d_in[4];
    const float* m_norm_w = (const float*)d_in[5];
    const float* r_mu_rkv = (const float*)d_in[6];
    const float* r_mu_w = (const float*)d_in[7];
    const float* r_mu_a = (const float*)d_in[8];
    const float* r_mu_g = (const float*)d_in[9];
    const float* r_w0 = (const float*)d_in[10];
    const float* r_w2 = (const float*)d_in[11];
    const float* r_a0 = (const float*)d_in[12];
    const float* r_a2 = (const float*)d_in[13];
    const float* r_g2 = (const float*)d_in[14];
    const float* r_k_k = (const float*)d_in[15];
    const float* r_k_a = (const float*)d_in[16];
    const float* r_r_k = (const float*)d_in[17];
    const float* r_ln_x = (const float*)d_in[18];
    const float* a_sinks = (const float*)d_in[19];
    const float* w_out = (const float*)d_in[20];
    const float* ln_mix = (const float*)d_in[21];
    const float* w_ff_in = (const float*)d_in[22];
    const float* w_ff_out = (const float*)d_in[23];
    const float* ln_ffn = (const float*)d_in[24];
    float* out = (float*)d_out;
    char* ws = (char*)d_ws;
    const size_t SZ_H = (size_t)T * D * 4;
    const size_t SZ_PP = (size_t)T * MP * 4;
    const size_t SZ_S = (size_t)T * 256 * 4;
    float* h32 = (float*)ws;
    float* mix = (float*)(ws + SZ_H);
    float* pp = (float*)(ws + 2 * SZ_H);
    float* s0 = (float*)(ws + 2 * SZ_H + SZ_PP);
    float* s1 = s0 + (size_t)T * 256;
    float* s2 = s1 + (size_t)T * 256;
    float* s3 = out;
    float* s4 = s3 + (size_t)T * 256;
    float* s5 = s4 + (size_t)T * 256;
    float* act = pp;
    if (2 * SZ_H + SZ_PP + 3 * SZ_S > ws_size) { fprintf(stderr, "ws too small: %zu\n", ws_size); return; }
    static bool attr = false;
    if (!attr) { hipFuncSetAttribute((const void*)k_mlstm, hipFuncAttributeMaxDynamicSharedMemorySize, 96 * 1024); attr = true; }

    k_init_h<<<T, 256, 0, stream>>>(x, meta, h32);
    const int MT = (T + 63) / 64;
    for (int l = 0; l < DEPTH; ++l) {
        const float* wi = w_in + (size_t)l * D * IN_DIM;
        k_gemm<0><<<dim3(AP / 64, MT), 256, 0, stream>>>(h32, D, wi, IN_DIM, 0, 0, pp, AP, T, AP, D);
        k_attn<<<(T * 8) / 4, 256, 0, stream>>>(pp, rel_bias, a_sinks + l * 8, mix);
        k_gemm<0><<<dim3((MP + 63) / 64, MT), 256, 0, stream>>>(h32, D, wi, IN_DIM, 768, 0, pp, MP, T, MP, D);
        k_mlstm<<<8, 256, (5 * 64 * 65 + 64 * 8 + 16) * 4, stream>>>(pp, m_gate_bias + l * 8, m_norm_w + l * 256, mix);
        k_gemm<0><<<dim3(RP / 64, MT), 256, 0, stream>>>(h32, D, wi, IN_DIM, 1800, 0, pp, RP, T, RP, D);
        RwkvW rw{r_mu_rkv + l * 768, r_mu_w + l * 32, r_mu_a + l * 32, r_mu_g + l * 64, r_w0 + l * 256, r_w2 + l * 32 * 256, r_a0 + l * 256, r_a2 + l * 32 * 256,
                 r_g2 + l * 64 * 256, r_k_k + l * 256, r_k_a + l * 256, r_r_k + l * 256, r_ln_x + l * 512};
        k_rwkv_prep<<<T, 256, 0, stream>>>(pp, rw, s0, s1, s2, s3, s4, s5);
        k_rwkv_scan<<<8, 1024, 0, stream>>>(s0, s1, s2, s3, s4, s5);
        k_rwkv_post<<<T, 256, 0, stream>>>(pp, rw, s0, s2, s3, mix);
        k_gemm<0><<<dim3(D / 64, MT), 256, 0, stream>>>(mix, D, w_out + (size_t)l * D * D, D, 0, 0, pp, D, T, D, D);
        k_resid_ln<<<T, 256, 0, stream>>>(h32, pp, ln_mix + l * 2 * D, ln_mix + l * 2 * D + D, nullptr);
        const float* wfi = w_ff_in + (size_t)l * D * 2 * DFF;
        const float* wfo = w_ff_out + (size_t)l * DFF * D;
        for (int hf = 0; hf < 2; ++hf) {
            k_gemm<2><<<dim3(1408 / 64, MT), 256, 0, stream>>>(h32, D, wfi, 2 * DFF, hf * 1408, DFF + hf * 1408, act, 1408, T, 1408, D);
            if (hf == 0) k_gemm<0><<<dim3(D / 64, MT), 256, 0, stream>>>(act, 1408, wfo + (size_t)hf * 1408 * D, D, 0, 0, mix, D, T, D, 1408);
            else         k_gemm<1><<<dim3(D / 64, MT), 256, 0, stream>>>(act, 1408, wfo + (size_t)hf * 1408 * D, D, 0, 0, mix, D, T, D, 1408);
        }
        k_resid_ln<<<T, 256, 0, stream>>>(h32, mix, ln_ffn + l * 2 * D, ln_ffn + l * 2 * D + D, l == DEPTH - 1 ? out : nullptr);
    }
}
```
